# Optimizing an MI355X kernel written in HIP

```python
import math
import jax, jax.numpy as jnp
from jax import lax
import numpy as np

D_MODEL = 1024
BATCH = 16
SEQ = 2048
DEPTH = 1

HEAD_DIM = 64
ATTN_WIDTH = D_MODEL // 2
N_ATTN_HEADS = ATTN_WIDTH // HEAD_DIM
DILATED_CONFIGS = ((128, 1), (512, 4), (2048, 16))
SGU_WIDTH = D_MODEL // 4
N_SGU_GROUPS = 4
SGU_GROUP = SGU_WIDTH // N_SGU_GROUPS
SGU_CHUNK = 128
MEM_WIDTH = D_MODEL // 4
N_MEM_HEADS = 4
MEM_HEAD_DIM = MEM_WIDTH // N_MEM_HEADS
N_MEM = 256
MIX_WIDTH = ATTN_WIDTH + SGU_WIDTH + MEM_WIDTH
IN_COLS = 4 * ATTN_WIDTH + 3 * SGU_WIDTH + 2 * MEM_WIDTH
EPS = 1e-6
NEG_INF = -1e30

kernel_name = "hybrid_dilated_sgu_memory_encoder"


def rmsnorm(x, g):
    xf = x.astype(jnp.float32)
    y = xf * lax.rsqrt(jnp.mean(xf * xf, axis=-1, keepdims=True) + EPS) * g.astype(jnp.float32)
    return y.astype(x.dtype)


def alibi_slopes(n):
    return jnp.power(2.0, -8.0 * (jnp.arange(n, dtype=jnp.float32) + 1.0) / n)


def dilated_window_attention(q, k, v, slopes, window, dilation):
    B, S, H, E = q.shape
    radius = window // (2 * dilation)
    blk = radius
    L = S // dilation
    N = B * dilation
    nb = -(-L // blk)
    Lp = nb * blk

    def to_sub(t):
        return t.reshape(B, L, dilation, H, E).transpose(0, 2, 1, 3, 4).reshape(N, L, H, E)

    qs = jnp.pad(to_sub(q), ((0, 0), (0, Lp - L), (0, 0), (0, 0))).reshape(N, nb, blk, H, E)

    def neighbour_blocks(t):
        tp = jnp.pad(to_sub(t), ((0, 0), (blk, Lp - L + blk), (0, 0), (0, 0))).reshape(N, nb + 2, blk, H, E)
        return jnp.concatenate([tp[:, :-2], tp[:, 1:-1], tp[:, 2:]], axis=2)

    kb = neighbour_blocks(k)
    vb = neighbour_blocks(v)
    q_idx = jnp.arange(Lp).reshape(nb, blk)
    k_idx = (jnp.arange(nb) * blk)[:, None] - blk + jnp.arange(3 * blk)[None, :]
    rel = jnp.abs(k_idx[:, None, :] - q_idx[:, :, None])
    valid = (rel <= radius) & (k_idx[:, None, :] >= 0) & (k_idx[:, None, :] < L)
    dist = (rel * dilation).astype(jnp.float32)

    s = jnp.einsum('nbqhe,nbkhe->nhbqk', qs.astype(jnp.float32), kb.astype(jnp.float32)) * (E ** -0.5)
    s = s - slopes[None, :, None, None, None] * dist[None, None]
    s = jnp.where(valid[None, None], s, NEG_INF)
    m = jnp.max(s, axis=-1, keepdims=True)
    p = jnp.exp(s - m)
    l = jnp.sum(p, axis=-1)
    o = jnp.einsum('nhbqk,nbkhe->nbqhe', p, vb.astype(jnp.float32))
    o = o / jnp.transpose(l, (0, 2, 3, 1))[..., None]
    lse = m[..., 0] + jnp.log(l)

    o = o.reshape(N, Lp, H, E)[:, :L].reshape(B, dilation, L, H, E).transpose(0, 2, 1, 3, 4).reshape(B, S, H, E)
    lse = lse.reshape(N, H, Lp)[..., :L].reshape(B, dilation, H, L).transpose(0, 3, 1, 2).reshape(B, S, H)
    return o, lse


def mixture_of_dilations(q, k, v):
    slopes = alibi_slopes(q.shape[2])
    outs, lses = [], []
    for window, dilation in DILATED_CONFIGS:
        o, lse = dilated_window_attention(q, k, v, slopes, window, dilation)
        outs.append(o)
        lses.append(lse)
    w = jax.nn.softmax(jnp.stack(lses, axis=0), axis=0)
    return jnp.sum(w[..., None] * jnp.stack(outs, axis=0), axis=0)


def chunked_spatial_gating(u, v, g_v, w_s, b_s):
    B, S, _ = v.shape
    n = S // SGU_CHUNK
    vn = rmsnorm(v, g_v).reshape(B, n, SGU_CHUNK, N_SGU_GROUPS, SGU_GROUP).astype(jnp.float32)
    mixed = jnp.einsum('gts,bnsgc->bntgc', w_s.astype(jnp.float32), vn)
    mixed = mixed + b_s.astype(jnp.float32).T[None, None, :, :, None]
    return u.astype(jnp.float32) * mixed.reshape(B, S, SGU_WIDTH)


def memory_cross_attention(q, mem, g_mem, w_mem_kv):
    B, M, _ = mem.shape
    kv = rmsnorm(mem, g_mem) @ w_mem_kv
    k, v = jnp.split(kv, 2, axis=-1)
    k = k.reshape(B, M, N_MEM_HEADS, MEM_HEAD_DIM).astype(jnp.float32)
    v = v.reshape(B, M, N_MEM_HEADS, MEM_HEAD_DIM).astype(jnp.float32)
    s = jnp.einsum('bshe,bmhe->bhsm', q.astype(jnp.float32), k) * (MEM_HEAD_DIM ** -0.5)
    p = jax.nn.softmax(s, axis=-1)
    return jnp.einsum('bhsm,bmhe->bshe', p, v)


def hybrid_layer(x, mem, g_norm, w_in, w_s, b_s, g_v, g_mem, w_mem_kv, w_out):
    B, S, _ = x.shape
    h = rmsnorm(x, g_norm)
    proj = h @ w_in
    offs = np.cumsum([ATTN_WIDTH] * 4 + [SGU_WIDTH] * 3 + [MEM_WIDTH])
    qa, ka, va, za, ub, vb, zb, qm, zm = jnp.split(proj, list(offs), axis=-1)

    shp = (B, S, N_ATTN_HEADS, HEAD_DIM)
    a = mixture_of_dilations(qa.reshape(shp), ka.reshape(shp), va.reshape(shp)).reshape(B, S, ATTN_WIDTH)
    sg = chunked_spatial_gating(jax.nn.gelu(ub), jax.nn.gelu(vb), g_v, w_s, b_s)
    mo = memory_cross_attention(qm.reshape(B, S, N_MEM_HEADS, MEM_HEAD_DIM), mem, g_mem, w_mem_kv)
    mo = mo.reshape(B, S, MEM_WIDTH)

    gated = jnp.concatenate([
        jax.nn.silu(za.astype(jnp.float32)) * a,
        jax.nn.silu(zb.astype(jnp.float32)) * sg,
        jax.nn.silu(zm.astype(jnp.float32)) * mo,
    ], axis=-1).astype(x.dtype)
    return x + gated @ w_out


def setup_inputs(seed: int = 0) -> dict:
    key = jax.random.key(seed)
    ks = jax.random.split(key, 12)
    f32 = jnp.float32
    x = jax.random.normal(ks[0], (BATCH, SEQ, D_MODEL), f32)
    mem = jax.random.normal(ks[1], (BATCH, N_MEM, D_MODEL), f32)
    g_norm = 1.0 + 0.02 * jax.random.normal(ks[2], (DEPTH, D_MODEL), f32)
    w_in = jax.random.normal(ks[3], (DEPTH, D_MODEL, IN_COLS), f32) * D_MODEL ** -0.5
    w_sgu_spatial = jax.random.normal(ks[4], (DEPTH, N_SGU_GROUPS, SGU_CHUNK, SGU_CHUNK), f32) * (0.5 * SGU_CHUNK ** -0.5)
    b_sgu_spatial = 1.0 + 0.02 * jax.random.normal(ks[5], (DEPTH, N_SGU_GROUPS, SGU_CHUNK), f32)
    g_sgu_v = 1.0 + 0.02 * jax.random.normal(ks[6], (DEPTH, SGU_WIDTH), f32)
    g_mem = 1.0 + 0.02 * jax.random.normal(ks[7], (DEPTH, D_MODEL), f32)
    w_mem_kv = jax.random.normal(ks[8], (DEPTH, D_MODEL, 2 * MEM_WIDTH), f32) * D_MODEL ** -0.5
    w_out = jax.random.normal(ks[9], (DEPTH, MIX_WIDTH, D_MODEL), f32) * MIX_WIDTH ** -0.5
    g_final = 1.0 + 0.02 * jax.random.normal(ks[10], (D_MODEL,), f32)
    return {"x": x, "mem": mem, "g_norm": g_norm, "w_in": w_in,
            "w_sgu_spatial": w_sgu_spatial, "b_sgu_spatial": b_sgu_spatial, "g_sgu_v": g_sgu_v,
            "g_mem": g_mem, "w_mem_kv": w_mem_kv, "w_out": w_out, "g_final": g_final}


def reference(x, mem, g_norm, w_in, w_sgu_spatial, b_sgu_spatial, g_sgu_v, g_mem, w_mem_kv, w_out, g_final):
    h = x
    for layer in range(DEPTH):
        h = hybrid_layer(h, mem, g_norm[layer], w_in[layer], w_sgu_spatial[layer], b_sgu_spatial[layer],
                         g_sgu_v[layer], g_mem[layer], w_mem_kv[layer], w_out[layer])
    return rmsnorm(h, g_final)
```

```cpp
#include <hip/hip_runtime.h>
#include <cstdio>
#include <cstdint>
namespace pg8 {
#define PG8_LAS __attribute__((address_space(3)))
typedef unsigned short bf16_t;
typedef short bf16x8 __attribute__((ext_vector_type(8)));
typedef float f32x4 __attribute__((ext_vector_type(4)));
typedef unsigned u32x4 __attribute__((ext_vector_type(4)));
constexpr int BM = 256, BK = 64, HALF = 128, HTB = HALF * BK * 2  , STAGE_BYTES = 8 * HTB, NXCD = 8, WGM = 8;

__host__ __device__ __forceinline__ int lds_byte(int r, int c) { const int st = (r >> 4) * 2 + (c >> 5), rr = r & 15, cc = c & 31, ob = rr * 64 + cc * 2; return st * 1024 + (ob ^ (((ob >> 9) & 1) << 5)); }
__host__ __device__ __forceinline__ void stage_rc(int b, int& R, int& C) { const int st = b / 1024, sb = b % 1024, swz = sb ^ (((sb >> 9) & 1) << 5); R = (st >> 1) * 16 + swz / 64; C = (st & 1) * 32 + (swz % 64) / 2; }
__host__ __device__ __forceinline__ int perm32(int rho) { const int n = rho >> 4, i = rho & 15; return 8 * (i >> 2) + 4 * n + (i & 3); }

struct Unit { int pm, pn; };
struct Gemm { const bf16_t* A; const bf16_t* Bt; int M, N, K; };

struct StaticOrder {
    int nM, nN, nwg, G, c;
    __host__ __device__ void init(int M, int N, int G_, int c_) { nM = M / BM; nN = N / BM; nwg = nM * nN; G = G_; c = c_; }
    __host__ __device__ bool next(int i, Unit& u) const {
        const long L = (long)i * G + c; if (L >= nwg) return false;
        int wgid = (int)L; { const int q = nwg / NXCD, r = nwg % NXCD, xcd = wgid % NXCD, off = wgid / NXCD; wgid = (xcd < r ? xcd * (q + 1) : r * (q + 1) + (xcd - r) * q) + off; }
        const int nig = WGM * nN, gid = wgid / nig, fm = gid * WGM, gsz = (nM - fm) < WGM ? (nM - fm) : WGM;
        u.pm = fm + ((wgid % nig) % gsz); u.pn = (wgid % nig) / gsz; return true;
    }
    __device__ __forceinline__ void a_ready(const Unit&) const {}
    __device__ __forceinline__ void done(const Unit&) const {}
};

__device__ __forceinline__ unsigned cvt_pk_bf16(float lo, float hi) { unsigned r; asm volatile("v_cvt_pk_bf16_f32 %0, %1, %2" : "=v"(r) : "v"(lo), "v"(hi)); return r; }
typedef float f32x2 __attribute__((ext_vector_type(2)));
template <class Epi, class Sched, bool ALIGN_EPI = false, bool SP2 = false>
__device__ __forceinline__ void gemm_phase(PG8_LAS unsigned char* lds, const Gemm g, const Sched& S, const Epi& E) {
    const int tid = threadIdx.x, wid = __builtin_amdgcn_readfirstlane(tid >> 6), lane = tid & 63, wr = wid >> 2, wc = wid & 3, fr = lane & 15, fq = lane >> 4;
    const int K = g.K, nt = K / BK;
    unsigned voffA[2], voffB[2];
#pragma unroll
    for (int i = 0; i < 2; ++i) { int R, C; stage_rc(tid * 16 + i * 8192, R, C); const int Rb = Epi::PERM ? ((R & ~31) + perm32(R & 31)) : R;
        voffA[i] = (unsigned)(R * K + C) * 2u; voffB[i] = (unsigned)(Rb * K + C) * 2u; }
    const size_t kstep = (size_t)(BK * 2);
    const size_t hstep = (size_t)HALF * K * 2;
    const size_t tstep = 2 * hstep;
    const unsigned ldsw = (unsigned)wid * 1024u;
    const int aoff = lds_byte(wr * 64 + fr, fq * 8), boff = lds_byte(wc * 32 + fr, fq * 8);
#define PG8_SA(b, h) (((b) * 2 + (h)) * HTB)
#define PG8_SB(b, h) ((4 + (b) * 2 + (h)) * HTB)
#define PG8_STAGE(bufoff, gbase, voff) do { _Pragma("unroll") for (int _i = 0; _i < 2; ++_i) \
        __builtin_amdgcn_global_load_lds((const unsigned*)((const char*)(gbase) + (voff)[_i]), (PG8_LAS unsigned*)(lds + (bufoff) + ldsw + _i * 8192), 16, 0, 0); } while (0)
#define PG8_LDA(dst, b, h) do { _Pragma("unroll") for (int m = 0; m < 4; ++m) _Pragma("unroll") for (int k = 0; k < 2; ++k) dst[m][k] = *(const PG8_LAS bf16x8*)(lds + PG8_SA(b, h) + aoff + m * 2048 + k * 1024); } while (0)
#define PG8_LDB(dst, b, h) do { _Pragma("unroll") for (int n = 0; n < 2; ++n) _Pragma("unroll") for (int k = 0; k < 2; ++k) dst[n][k] = *(const PG8_LAS bf16x8*)(lds + PG8_SB(b, h) + boff + n * 2048 + k * 1024); } while (0)
#define PG8_MMA(ai, bj, At, Bt) do { __builtin_amdgcn_s_setprio(1); _Pragma("unroll") for (int m = 0; m < 4; ++m) _Pragma("unroll") for (int n = 0; n < 2; ++n) _Pragma("unroll") for (int k = 0; k < 2; ++k) \
        acc[ai][bj][m][n] = __builtin_amdgcn_mfma_f32_16x16x32_bf16(Bt[n][k], At[m][k], acc[ai][bj][m][n], 0, 0, 0); __builtin_amdgcn_s_setprio(0); } while (0)
#define PG8_WAIT_V(n) asm volatile("s_waitcnt vmcnt(" #n ")" ::: "memory")
#define PG8_WAIT_L(n) asm volatile("s_waitcnt lgkmcnt(" #n ")" ::: "memory")
#define PG8_BAR __builtin_amdgcn_s_barrier()
#define PG8_SCHED __builtin_amdgcn_sched_barrier(0)
    Unit cur, nxt; int ui = 0;
    if (!S.next(0, cur)) return;
    f32x4 acc[2][2][4][2];
#pragma unroll
    for (int a = 0; a < 2; ++a)
#pragma unroll
        for (int b = 0; b < 2; ++b)
#pragma unroll
            for (int m = 0; m < 4; ++m)
#pragma unroll
                for (int n = 0; n < 2; ++n) acc[a][b][m][n] = (f32x4){0.f, 0.f, 0.f, 0.f};
    bf16x8 At[4][2], B0[2][2], B1[2][2];
    const char* cA = (const char*)g.A + (size_t)cur.pm * tstep; const char* cB = (const char*)g.Bt + (size_t)cur.pn * tstep;
    S.a_ready(cur);
    if constexpr (SP2) {
        PG8_STAGE(PG8_SB(0, 0), cB, voffB); PG8_STAGE(PG8_SB(0, 1), cB + hstep, voffB); PG8_STAGE(PG8_SA(0, 0), cA, voffA); PG8_STAGE(PG8_SA(0, 1), cA + hstep, voffA);
        if (wr == 1) PG8_BAR;
        PG8_WAIT_V(2); PG8_BAR;
        PG8_STAGE(PG8_SB(1, 0), cB + kstep, voffB); PG8_STAGE(PG8_SA(1, 0), cA + kstep, voffA); PG8_STAGE(PG8_SB(1, 1), cB + hstep + kstep, voffB);
        PG8_WAIT_V(6); PG8_BAR;
    } else {
        PG8_STAGE(PG8_SB(0, 0), cB, voffB); PG8_STAGE(PG8_SA(0, 0), cA, voffA); PG8_STAGE(PG8_SB(0, 1), cB + hstep, voffB); PG8_STAGE(PG8_SA(0, 1), cA + hstep, voffA);
        if (wr == 1) PG8_BAR;
        PG8_WAIT_V(4); PG8_BAR;
        PG8_STAGE(PG8_SB(1, 0), cB + kstep, voffB); PG8_STAGE(PG8_SA(1, 0), cA + kstep, voffA); PG8_STAGE(PG8_SB(1, 1), cB + hstep + kstep, voffB);
        PG8_WAIT_V(6); PG8_BAR;
    }
    for (;;) {
        const bool has_next = S.next(ui + 1, nxt);
        const char* nA = has_next ? (const char*)g.A + (size_t)nxt.pm * tstep : cA; const char* nB = has_next ? (const char*)g.Bt + (size_t)nxt.pn * tstep : cB;
        for (int t = 0; t < nt; t += 2) {
            const bool last = (t == nt - 2);
            const char* a1 = cA + (size_t)(t + 1) * kstep;
            const char* a2 = last ? nA : cA + (size_t)(t + 2) * kstep; const char* b2 = last ? nB : cB + (size_t)(t + 2) * kstep;
            const char* a3 = a2 + kstep; const char* b3 = b2 + kstep;
            if (last && has_next) S.a_ready(nxt);
            if constexpr (SP2) {
            PG8_LDB(B0, 0, 0); PG8_LDB(B1, 0, 1); PG8_SCHED; PG8_LDA(At, 0, 0); PG8_STAGE(PG8_SA(1, 1), a1 + hstep, voffA);
            PG8_WAIT_V(8); PG8_WAIT_L(0); PG8_BAR; PG8_MMA(0, 0, At, B0); PG8_MMA(0, 1, At, B1); PG8_BAR; PG8_SCHED;
            PG8_LDA(At, 0, 1); PG8_STAGE(PG8_SB(0, 0), b2, voffB); PG8_STAGE(PG8_SB(0, 1), b2 + hstep, voffB); PG8_STAGE(PG8_SA(0, 0), a2, voffA);
            PG8_WAIT_V(8); PG8_WAIT_L(0); PG8_BAR; PG8_MMA(1, 0, At, B0); PG8_MMA(1, 1, At, B1); PG8_BAR; PG8_SCHED;
            PG8_LDB(B0, 1, 0); PG8_LDB(B1, 1, 1); PG8_SCHED; PG8_LDA(At, 1, 0); PG8_STAGE(PG8_SA(0, 1), a2 + hstep, voffA);
            PG8_WAIT_V(8); PG8_WAIT_L(0); PG8_BAR; PG8_MMA(0, 0, At, B0); PG8_MMA(0, 1, At, B1); PG8_BAR; PG8_SCHED;
            PG8_LDA(At, 1, 1); PG8_STAGE(PG8_SB(1, 0), b3, voffB); PG8_STAGE(PG8_SB(1, 1), b3 + hstep, voffB); PG8_STAGE(PG8_SA(1, 0), a3, voffA);
            PG8_WAIT_V(8); PG8_WAIT_L(0); PG8_BAR; PG8_MMA(1, 0, At, B0); PG8_MMA(1, 1, At, B1); PG8_BAR; PG8_SCHED;
            } else {
            PG8_LDB(B0, 0, 0); PG8_SCHED; PG8_LDA(At, 0, 0); PG8_STAGE(PG8_SA(1, 1), a1 + hstep, voffA);
            PG8_WAIT_L(8); PG8_BAR; PG8_WAIT_L(0); PG8_MMA(0, 0, At, B0); PG8_BAR; PG8_SCHED;
            PG8_LDB(B1, 0, 1); PG8_STAGE(PG8_SB(0, 0), b2, voffB);
            PG8_BAR; PG8_WAIT_L(0); PG8_MMA(0, 1, At, B1); PG8_BAR;
            PG8_LDA(At, 0, 1); PG8_STAGE(PG8_SA(0, 0), a2, voffA);
            PG8_BAR; PG8_WAIT_L(0); PG8_MMA(1, 0, At, B0); PG8_BAR; PG8_SCHED;
            PG8_STAGE(PG8_SB(0, 1), b2 + hstep, voffB);
            PG8_WAIT_V(6); PG8_BAR; PG8_MMA(1, 1, At, B1); PG8_BAR;
            PG8_LDB(B0, 1, 0); PG8_SCHED; PG8_LDA(At, 1, 0); PG8_STAGE(PG8_SA(0, 1), a2 + hstep, voffA);
            PG8_WAIT_L(8); PG8_BAR; PG8_WAIT_L(0); PG8_MMA(0, 0, At, B0); PG8_BAR; PG8_SCHED;
            PG8_LDB(B1, 1, 1); PG8_STAGE(PG8_SB(1, 0), b3, voffB);
            PG8_BAR; PG8_WAIT_L(0); PG8_MMA(0, 1, At, B1); PG8_BAR;
            PG8_LDA(At, 1, 1); PG8_STAGE(PG8_SA(1, 0), a3, voffA);
            PG8_BAR; PG8_WAIT_L(0); PG8_MMA(1, 0, At, B0); PG8_BAR; PG8_SCHED;
            PG8_STAGE(PG8_SB(1, 1), b3 + hstep, voffB);
            PG8_WAIT_V(6); PG8_BAR; PG8_MMA(1, 1, At, B1); PG8_BAR;
            }
        }
        if constexpr (ALIGN_EPI) { if (wr == 0) PG8_BAR; }
        if constexpr (!Epi::AFTER_DRAIN) { E(acc, cur, wr, wc, fr, fq); S.done(cur); }
        if (!has_next) break;
#pragma unroll
        for (int a = 0; a < 2; ++a)
#pragma unroll
            for (int b = 0; b < 2; ++b)
#pragma unroll
                for (int m = 0; m < 4; ++m)
#pragma unroll
                    for (int n = 0; n < 2; ++n) acc[a][b][m][n] = (f32x4){0.f, 0.f, 0.f, 0.f};
        cur = nxt; cA = nA; cB = nB; ++ui;
        if constexpr (ALIGN_EPI) { if (wr == 1) PG8_BAR; }
    }
    PG8_WAIT_V(0);
    if constexpr (!ALIGN_EPI) { if (wr == 0) PG8_BAR; }
    PG8_BAR;
    if constexpr (Epi::AFTER_DRAIN) { E.fused(acc, cur, wr, wc, fr, fq, lds, wid, lane); S.done(cur); }
#undef PG8_SA
#undef PG8_SB
#undef PG8_STAGE
#undef PG8_LDA
#undef PG8_LDB
#undef PG8_MMA
#undef PG8_WAIT_V
#undef PG8_WAIT_L
#undef PG8_BAR
#undef PG8_SCHED
}
}
namespace pg8 {
__device__ __forceinline__ float silu_f(float x) { return x * __builtin_amdgcn_rcpf(1.f + __builtin_amdgcn_exp2f(-1.4426950408889634f * x)); }
__device__ __forceinline__ float gelu_tanh_f(float x) { const float u = x * (1.f + 0.044715f * x * x); return x * __builtin_amdgcn_rcpf(1.f + __builtin_amdgcn_exp2f(-2.3022081982f * u)); }
constexpr float QSCALE = 0.125f * 1.4426950408889634f;
constexpr unsigned PROJ_KINDS = 1u | (1u << 2) | (2u << 12) | (2u << 14) | (3u << 16) | (3u << 18) | (2u << 20) | (1u << 22) | (2u << 24);
constexpr int PROJ_LD = 3328, MKV_LD = 512, PROJ_NT = 13, X_MT = 128;

struct SchedP1 {
    int G, c;
    __device__ __forceinline__ bool next(int i, Unit& u) const {
        constexpr int NWG = X_MT * PROJ_NT;
        const int L = i * G + c;
        if (L < NWG) { const int q = NWG / NXCD, xcd = L % NXCD, off = L / NXCD; const int wgid = xcd * q + off;
            const int nig = WGM * PROJ_NT, gid = wgid / nig, fm = gid * WGM, x = wgid % nig; u.pm = fm + (x % WGM); u.pn = x / WGM; return true; }
        const int j = L - NWG; if (j >= 32) return false;
        u.pm = X_MT + (j & 15); u.pn = PROJ_NT + (j >> 4); return true;
    }
    __device__ __forceinline__ void a_ready(const Unit&) const {}
    __device__ __forceinline__ void done(const Unit&) const {}
};

struct EpiProj {
    static constexpr bool PERM = true, AFTER_DRAIN = false;
    bf16_t* proj; bf16_t* mkv;
    template <int ACT> __device__ __forceinline__ void body(const f32x4 (&acc)[2][2][4][2], bf16_t* base, int ldc) const {
#pragma unroll
        for (int ai = 0; ai < 2; ++ai)
#pragma unroll
            for (int m = 0; m < 4; ++m) { bf16_t* rowp = base + (size_t)(ai * HALF + m * 16) * ldc;
#pragma unroll
                for (int bj = 0; bj < 2; ++bj) { f32x4 v0 = acc[ai][bj][m][0], v1 = acc[ai][bj][m][1];
                    if (ACT == 1) { v0 = v0 * QSCALE; v1 = v1 * QSCALE; }
                    if (ACT == 2) {
#pragma unroll
                        for (int k = 0; k < 4; ++k) { v0[k] = silu_f(v0[k]); v1[k] = silu_f(v1[k]); } }
                    if (ACT == 3) {
#pragma unroll
                        for (int k = 0; k < 4; ++k) { v0[k] = gelu_tanh_f(v0[k]); v1[k] = gelu_tanh_f(v1[k]); } }
                    u32x4 w; w.x = cvt_pk_bf16(v0[0], v0[1]); w.y = cvt_pk_bf16(v0[2], v0[3]); w.z = cvt_pk_bf16(v1[0], v1[1]); w.w = cvt_pk_bf16(v1[2], v1[3]);
                    *(u32x4*)(rowp + bj * HALF) = w; } }
    }
    __device__ __forceinline__ void operator()(const f32x4 (&acc)[2][2][4][2], const Unit& u, int wr, int wc, int fr, int fq) const {
        bf16_t* base; int ldc, kind;
        if (u.pn < PROJ_NT) { base = proj + (size_t)(u.pm * BM) * PROJ_LD + u.pn * BM; ldc = PROJ_LD; kind = (int)((PROJ_KINDS >> (2 * u.pn)) & 3u); }
        else { base = mkv + (size_t)((u.pm - X_MT) * BM) * MKV_LD + (u.pn - PROJ_NT) * BM; ldc = MKV_LD; kind = 0; }
        base += (size_t)(wr * 64 + fr) * ldc + wc * 32 + 8 * fq;
        if (kind == 0) body<0>(acc, base, ldc); else if (kind == 1) body<1>(acc, base, ldc); else if (kind == 2) body<2>(acc, base, ldc); else body<3>(acc, base, ldc);
    }
};

struct EpiRes {
    static constexpr bool PERM = false, AFTER_DRAIN = false;
    const float* x; float* out;
    __device__ __forceinline__ void operator()(const f32x4 (&acc)[2][2][4][2], const Unit& u, int wr, int wc, int fr, int fq) const {
        const int row0 = u.pm * BM + wr * 64 + fr, col0 = u.pn * BM + wc * 32 + 4 * fq;
#pragma unroll
        for (int ai = 0; ai < 2; ++ai)
#pragma unroll
            for (int m = 0; m < 4; ++m) { const size_t off = (size_t)(row0 + ai * HALF + m * 16) * 1024 + col0;
#pragma unroll
                for (int bj = 0; bj < 2; ++bj)
#pragma unroll
                    for (int n = 0; n < 2; ++n) { const f32x4 xv = *(const f32x4*)(x + off + bj * HALF + n * 16); *(f32x4*)(out + off + bj * HALF + n * 16) = xv + acc[ai][bj][m][n]; } }
    }
};
}
#define GAS __attribute__((address_space(1)))
#define LAS __attribute__((address_space(3)))
typedef unsigned short bf16;
typedef unsigned v4u __attribute__((ext_vector_type(4)));
typedef float f32x4 __attribute__((ext_vector_type(4)));
typedef short bf16x8 __attribute__((ext_vector_type(8)));
typedef GAS unsigned gu32;
typedef GAS unsigned long long gu64;
#define RLX_AGENT __ATOMIC_RELAXED, __HIP_MEMORY_SCOPE_AGENT
#define LDS_WAIT() asm volatile("s_waitcnt lgkmcnt(0)" ::: "memory")
#define VM_WAIT() asm volatile("s_waitcnt vmcnt(0)" ::: "memory")
__device__ __forceinline__ unsigned long long rt() { return __builtin_amdgcn_s_memrealtime(); }
__device__ __forceinline__ unsigned f2bf(float f) { unsigned u = __builtin_bit_cast(unsigned, f); return (u + 0x7fffu + ((u >> 16) & 1u)) >> 16; }
__device__ __forceinline__ unsigned pk2(float lo, float hi) { return f2bf(lo) | (f2bf(hi) << 16); }
#define XB_TMO      128
#define XB_XCNT(j)  (256  + 64 * (j))
#define XB_XSUB(j)  (1280 + 64 * (j))
#define XB_XGEN(j)  (2304 + 64 * (j))
#define XB_TOP      3328
#define XB_TOPGEN   3392
#define XCD_BAR_WORDS 3456
#define XB_SPIN_CAP (1u << 18)

__device__ __forceinline__ unsigned xb_ld(unsigned* p)              { return __hip_atomic_load(p, __ATOMIC_RELAXED, __HIP_MEMORY_SCOPE_AGENT); }
__device__ __forceinline__ unsigned xb_add(unsigned* p, unsigned v) { return __hip_atomic_fetch_add(p, v, __ATOMIC_RELAXED, __HIP_MEMORY_SCOPE_AGENT); }
__device__ __forceinline__ unsigned xb_xcc_id() { return (unsigned)__builtin_amdgcn_s_getreg((3 << 11) | 20) & 0xFu; }
#define XB_SPIN(cond, bar) do { unsigned _sp = 0; while (cond) { __builtin_amdgcn_s_sleep(1); \
    if ((++_sp & 255u) == 0u) { if (xb_ld(&(bar)[XB_TMO])) break; if (_sp > XB_SPIN_CAP) { atomicAdd(&(bar)[XB_TMO], 1u); break; } } } } while (0)

struct XcdBarrier {
    unsigned* bar; unsigned x;
    volatile LAS unsigned* st;
};

__device__ __forceinline__ XcdBarrier xcd_barrier_post(unsigned* bar, volatile LAS unsigned* st) {
    XcdBarrier b; b.bar = bar; b.x = xb_xcc_id(); b.st = st;
    if (threadIdx.x == 0) (void)xb_add(&bar[XB_XCNT(b.x)], 1u);
    return b;
}
__device__ __forceinline__ void xcd_barrier_complete(unsigned* bar, unsigned x, unsigned& nloc, unsigned& nx) {
    const unsigned G = gridDim.x * gridDim.y * gridDim.z;
    unsigned sum, cnt, mine, sp = 0u;
    for (;;) {
        sum = 0u; cnt = 0u; mine = 0u;
#pragma unroll
        for (unsigned j = 0; j < 16; ++j) { const unsigned c = xb_ld(&bar[XB_XCNT(j)]); sum += c; cnt += (c > 0u) ? 1u : 0u; mine = (j == x) ? c : mine; }
        if (sum == G) break;
        __builtin_amdgcn_s_sleep(1);
        if ((++sp & 255u) == 0u) { if (xb_ld(&bar[XB_TMO])) break; if (sp > XB_SPIN_CAP) { atomicAdd(&bar[XB_TMO], 1u); break; } }
    }
    nloc = mine > 0u ? mine : 1u; nx = cnt > 0u ? cnt : 1u;
}

__device__ __forceinline__ void xcd_barrier(const XcdBarrier& b) {
    asm volatile("s_waitcnt vmcnt(0)" ::: "memory");
    __syncthreads();
    if (threadIdx.x == 0) {
        unsigned* bar = b.bar;
        __builtin_amdgcn_s_waitcnt(0);
        unsigned nloc = b.st[0], nx = b.st[1];
        if (nloc == 0u) { xcd_barrier_complete(bar, b.x, nloc, nx); b.st[0] = nloc; b.st[1] = nx; }
        const unsigned old = xb_add(&bar[XB_XSUB(b.x)], 1u);
        const unsigned gen = old / nloc;
        if (old + 1u == (gen + 1u) * nloc) {
            __builtin_amdgcn_fence(__ATOMIC_RELEASE, "agent");
            asm volatile("s_waitcnt vmcnt(0)" ::: "memory");
            const unsigned og = xb_add(&bar[XB_TOP], 1u);
            const unsigned tg = og / nx;
            if (og + 1u == (tg + 1u) * nx) xb_add(&bar[XB_TOPGEN], 1u);
            else XB_SPIN(xb_ld(&bar[XB_TOPGEN]) == tg, bar);
            __builtin_amdgcn_fence(__ATOMIC_ACQUIRE, "agent");
            xb_add(&bar[XB_XGEN(b.x)], 1u);
            asm volatile("s_waitcnt vmcnt(0)" ::: "memory");
        } else {
            XB_SPIN(xb_ld(&bar[XB_XGEN(b.x)]) == gen, bar);
            __builtin_amdgcn_fence(__ATOMIC_ACQUIRE, "agent");
            asm volatile("s_waitcnt vmcnt(0)" ::: "memory");
        }
    }
    __syncthreads();
}
__device__ __forceinline__ float wave_sum(float v) {
#pragma unroll
    for (int o = 1; o < 64; o <<= 1) v += __shfl_xor(v, o);
    return v;
}
__device__ __forceinline__ void p0_transpose_item(const float* W, int K, int N, bf16* WT, int row_off, LAS float* scr, int item, int lane) {
    const int nblk = N / 32, kb = item / nblk, nb = item % nblk, k0 = 64 * kb, n0 = 32 * nb;
#pragma unroll 8
    for (int i = 0; i < 32; ++i) { const int kk = 2 * i + (lane >> 5); scr[kk * 33 + (lane & 31)] = W[(size_t)(k0 + kk) * N + n0 + (lane & 31)]; }
    LDS_WAIT(); asm volatile("" ::: "memory");
    const int c = lane & 7;
#pragma unroll
    for (int j = 0; j < 4; ++j) { const int n = (lane >> 3) + 8 * j; const LAS float* s = scr + (8 * c) * 33 + n;
        v4u o; o.x = pk2(s[0 * 33], s[1 * 33]); o.y = pk2(s[2 * 33], s[3 * 33]); o.z = pk2(s[4 * 33], s[5 * 33]); o.w = pk2(s[6 * 33], s[7 * 33]);
        *(GAS v4u*)(WT + (size_t)(row_off + n0 + n) * K + k0 + 8 * c) = o; }
    LDS_WAIT(); asm volatile("" ::: "memory");
}
constexpr int NWAVES = 8;
constexpr int BATCH = 16, SEQ = 2048, DM = 1024, NTOK = BATCH * SEQ;
constexpr int NMEM = 256, MEMROWS = BATCH * NMEM;
constexpr int INC = 3328;
constexpr int C_QA = 0, C_KA = 512, C_VA = 1024, C_ZA = 1536, C_UB = 2048, C_VB = 2304, C_ZB = 2560, C_QM = 2816, C_ZM = 3072;
constexpr float RMS_EPS = 1e-6f;
constexpr float LOG2E = 1.4426950408889634f;
constexpr size_t MiB = 1u << 20;
constexpr size_t WS_CTL = 0, CTL_ZERO_BYTES = 64 * 1024;
constexpr size_t WS_BALL = 2 * MiB;
constexpr size_t WS_WOUT = 10 * MiB;
constexpr size_t WS_WS = 12 * MiB;
constexpr size_t WS_AALL = 16 * MiB;
constexpr size_t WS_PROJ = 88 * MiB;
constexpr size_t WS_MKV = 296 * MiB;
constexpr size_t WS_GATED = 300 * MiB;
constexpr size_t WS_END = 364 * MiB;
constexpr int CW_BAR = 4096;
constexpr int RING_OFF = 0;
constexpr int P2_OST = 0, P2_ML = 65536, P2_VST = 69632;
constexpr int LDSCTL_OFF = 143360, MISC_OFF = LDSCTL_OFF + 320;
constexpr int LDS_BYTES = 147456;
static_assert(P2_VST + NWAVES * 4096 <= LDSCTL_OFF && MISC_OFF + 128 <= LDS_BYTES, "LDS map");

typedef short s16x4 __attribute__((ext_vector_type(4)));
typedef short v4i16_t __attribute__((ext_vector_type(4)));
typedef float f32x16 __attribute__((ext_vector_type(16)));
typedef unsigned u32x2 __attribute__((ext_vector_type(2)));
typedef unsigned u32x4 __attribute__((ext_vector_type(4)));

struct Frame {
    LAS unsigned char* lds;
    volatile LAS unsigned* MISC;
    gu32* ctl;
    int tid, lane, wave, vcu, G;
    const float *x, *mem, *g_norm, *w_in, *w_s, *b_s, *g_v, *g_mem, *w_mkv, *w_out, *g_final;
    float* out;
    bf16 *BALL, *WOUT, *WSB, *AALL, *PROJ, *MKV, *GATED;
};

__device__ __forceinline__ void rms_row_to_bf16(const float* xrow, const float* gain, bf16* orow, int lane) {
    const GAS f32x4* xr = (const GAS f32x4*)xrow + lane; const GAS f32x4* gr = (const GAS f32x4*)gain + lane;
    f32x4 v[4]; float s = 0.f;
#pragma unroll
    for (int j = 0; j < 4; ++j) { v[j] = xr[64 * j]; s += (v[j].x * v[j].x + v[j].y * v[j].y) + (v[j].z * v[j].z + v[j].w * v[j].w); }
    const float rstd = 1.f / sqrtf(wave_sum(s) * (1.f / 1024.f) + RMS_EPS);
    GAS unsigned long long* o8 = (GAS unsigned long long*)orow + lane;
#pragma unroll
    for (int j = 0; j < 4; ++j) { const f32x4 g = gr[64 * j];
        o8[64 * j] = (unsigned long long)pk2(v[j].x * rstd * g.x, v[j].y * rstd * g.y) | ((unsigned long long)pk2(v[j].z * rstd * g.z, v[j].w * rstd * g.w) << 32); }
}
__device__ __forceinline__ void p0_prologue(Frame& F) {
    LAS float* scr = (LAS float*)(F.lds + RING_OFF + F.wave * 16384);
    const int gw = F.vcu * NWAVES + F.wave, NGW = F.G * NWAVES;
    constexpr int I_IN = (DM / 64) * (INC / 32), I_MKV = (DM / 64) * (512 / 32), I_OUT = (DM / 64) * (DM / 32);
    constexpr int NITEMS = I_IN + I_MKV + I_OUT;
    for (int it = gw; it < NITEMS; it += NGW) {
        int r = it;
        if (r < I_IN) { p0_transpose_item(F.w_in, DM, INC, F.BALL, 0, scr, r, F.lane); continue; } r -= I_IN;
        if (r < I_MKV) { p0_transpose_item(F.w_mkv, DM, 512, F.BALL, INC, scr, r, F.lane); continue; } r -= I_MKV;
        p0_transpose_item(F.w_out, DM, DM, F.WOUT, 0, scr, r, F.lane);
    }
    { const int gt = gw * 64 + F.lane, NGT = NGW * 64;
      for (int i = gt; i < 4 * 128 * 128 / 4; i += NGT) { const f32x4 v = ((const GAS f32x4*)F.w_s)[i];
          ((GAS unsigned long long*)F.WSB)[i] = (unsigned long long)pk2(v.x, v.y) | ((unsigned long long)pk2(v.z, v.w) << 32); } }
    for (int m = gw; m < NTOK + MEMROWS; m += NGW) {
        if (m < NTOK) rms_row_to_bf16(F.x + (size_t)m * DM, F.g_norm, F.AALL + (size_t)m * DM, F.lane);
        else rms_row_to_bf16(F.mem + (size_t)(m - NTOK) * DM, F.g_mem, F.AALL + (size_t)m * DM, F.lane);
    }
}

__device__ __forceinline__ unsigned cvtpk(float lo, float hi) { typedef float f2_t __attribute__((ext_vector_type(2))); typedef __bf16 b2_t __attribute__((ext_vector_type(2)));
    f2_t v = {lo, hi}; b2_t b = __builtin_convertvector(v, b2_t); return __builtin_bit_cast(unsigned, b); }
__device__ __forceinline__ float bflo(unsigned w) { return __uint_as_float(w << 16); }
__device__ __forceinline__ float bfhi(unsigned w) { return __uint_as_float(w & 0xffff0000u); }
__device__ __forceinline__ float pair_max(float v) { auto rr = __builtin_amdgcn_permlane32_swap(__float_as_uint(v), __float_as_uint(v), false, false); return fmaxf(__uint_as_float(rr[0]), __uint_as_float(rr[1])); }
__device__ __forceinline__ float pair_sum(float v) { auto rr = __builtin_amdgcn_permlane32_swap(__float_as_uint(v), __float_as_uint(v), false, false); return __uint_as_float(rr[0]) + __uint_as_float(rr[1]); }
__device__ __forceinline__ s16x4 vtr(const LAS unsigned char* p) { return __builtin_bit_cast(s16x4, __builtin_amdgcn_ds_read_tr16_b64_v4i16((LAS v4i16_t*)p)); }
#define MFMA32(a, b, c) __builtin_amdgcn_mfma_f32_32x32x16_bf16((a), (b), (c), 0, 0, 0)
constexpr float NEG_BIG = -1e30f;

template <bool DIL>
__device__ __forceinline__ void attn_block(f32x16& o0, f32x16& o1, float& m, float& l, const bf16x8 (&qf)[4], const bf16* kbase, const bf16* vbase, const int pitch,
                                           const int q0, const int L, const int dil, const int res, const float cb, LAS unsigned char* vst, const int lane) {
    const int r32 = lane & 31, hi = lane >> 5;
    int jlo, jhi, kofs;
    if (DIL) { jlo = q0 >= 64 ? 0 : (q0 >= 32 ? 1 : 2); jhi = (L + 32 - q0) >> 5; jhi = jhi > 4 ? 4 : jhi; kofs = q0 - 64; }
    else { jlo = 0; jhi = 7; kofs = 0; }
    const int vrow = lane >> 3, vch = lane & 7;
    LAS unsigned char* vw = vst + vrow * 128 + ((vch * 16) ^ (((vrow >> 1) & 1) << 6));
    const int tq = (lane & 15) >> 2, tp = lane & 3, tblk = (lane >> 4) & 1, tqb = tq >> 1;
    const LAS unsigned char* tr0 = vst + (4 * hi + tq) * 128 + 32 * tblk + 8 * tp + 64 * tqb;
    const LAS unsigned char* tr1 = vst + (4 * hi + tq) * 128 + 32 * tblk + 8 * tp + 64 * (1 ^ tqb);
    bf16x8 kc[4], kn[4]; u32x4 vn[4];
    {   const int kt0 = kofs + 32 * jlo;
        const int tk = DIL ? dil * (kt0 + r32) + res : (kt0 + r32);
        const bf16* kp = kbase + (size_t)tk * pitch + 8 * hi;
#pragma unroll
        for (int d0 = 0; d0 < 4; ++d0) kc[d0] = *(const bf16x8*)(kp + 16 * d0);
#pragma unroll
        for (int i = 0; i < 4; ++i) { const int tv = DIL ? dil * (kt0 + vrow + 8 * i) + res : (kt0 + vrow + 8 * i);
            vn[i] = *(const u32x4*)(vbase + (size_t)tv * pitch + 8 * vch); }
#pragma unroll
        for (int i = 0; i < 4; ++i) *(LAS u32x4*)(vw + i * 1024) = vn[i];
    }
    for (int jt = jlo; jt <= jhi; ++jt) {
        const bool more = jt < jhi;
        if (more) {
            const int kt1 = kofs + 32 * (jt + 1);
            const int tk = DIL ? dil * (kt1 + r32) + res : (kt1 + r32);
            const bf16* kp = kbase + (size_t)tk * pitch + 8 * hi;
#pragma unroll
            for (int d0 = 0; d0 < 4; ++d0) kn[d0] = *(const bf16x8*)(kp + 16 * d0);
#pragma unroll
            for (int i = 0; i < 4; ++i) { const int tv = DIL ? dil * (kt1 + vrow + 8 * i) + res : (kt1 + vrow + 8 * i);
                vn[i] = *(const u32x4*)(vbase + (size_t)tv * pitch + 8 * vch); }
        }
        f32x16 s;
#pragma unroll
        for (int r = 0; r < 16; ++r) s[r] = 0.f;
#pragma unroll
        for (int d0 = 0; d0 < 4; ++d0) s = MFMA32(kc[d0], qf[d0], s);
        if (DIL) {
            const float relb = (float)((kofs + 32 * jt - q0) + 4 * hi - r32);
#pragma unroll
            for (int r = 0; r < 16; ++r) { const float ar = fabsf(relb + (float)((r & 3) + 8 * (r >> 2))); const float sv = s[r] - cb * ar; s[r] = ar <= 64.f ? sv : NEG_BIG; }
        }
        float mx = fmaxf(s[0], s[1]);
#pragma unroll
        for (int r = 2; r < 16; ++r) mx = fmaxf(mx, s[r]);
        mx = pair_max(mx);
        const float mn = fmaxf(m, mx), alpha = __builtin_amdgcn_exp2f(m - mn); m = mn;
        float ls = 0.f;
#pragma unroll
        for (int r = 0; r < 16; ++r) { s[r] = __builtin_amdgcn_exp2f(s[r] - mn); ls += s[r]; }
        l = l * alpha + ls;
#pragma unroll
        for (int r = 0; r < 16; ++r) { o0[r] *= alpha; o1[r] *= alpha; }
        u32x4 w0, w1;
        w0.x = cvtpk(s[0], s[1]); w0.y = cvtpk(s[2], s[3]); w0.z = cvtpk(s[4], s[5]); w0.w = cvtpk(s[6], s[7]);
        w1.x = cvtpk(s[8], s[9]); w1.y = cvtpk(s[10], s[11]); w1.z = cvtpk(s[12], s[13]); w1.w = cvtpk(s[14], s[15]);
        const bf16x8 pk0 = __builtin_bit_cast(bf16x8, w0), pk1 = __builtin_bit_cast(bf16x8, w1);
        {
            const s16x4 a00 = vtr(tr0), a01 = vtr(tr0 + 1024), a10 = vtr(tr0 + 2048), a11 = vtr(tr0 + 3072);
            const s16x4 b00 = vtr(tr1), b01 = vtr(tr1 + 1024), b10 = vtr(tr1 + 2048), b11 = vtr(tr1 + 3072);
            const bf16x8 va0 = __builtin_shufflevector(a00, a01, 0, 1, 2, 3, 4, 5, 6, 7), va1 = __builtin_shufflevector(a10, a11, 0, 1, 2, 3, 4, 5, 6, 7);
            const bf16x8 vb0 = __builtin_shufflevector(b00, b01, 0, 1, 2, 3, 4, 5, 6, 7), vb1 = __builtin_shufflevector(b10, b11, 0, 1, 2, 3, 4, 5, 6, 7);
            o0 = MFMA32(va0, pk0, o0); o0 = MFMA32(va1, pk1, o0);
            o1 = MFMA32(vb0, pk0, o1); o1 = MFMA32(vb1, pk1, o1);
        }
        if (more) {
#pragma unroll
            for (int i = 0; i < 4; ++i) *(LAS u32x4*)(vw + i * 1024) = vn[i];
#pragma unroll
            for (int d0 = 0; d0 < 4; ++d0) kc[d0] = kn[d0];
        }
    }
}

__device__ __forceinline__ void attn_finish(const f32x16& o0, const f32x16& o1, float l, const bf16* zrow, bf16* orow, int hi) {
    const float inv = 1.f / pair_sum(l);
#pragma unroll
    for (int c = 0; c < 2; ++c)
#pragma unroll
        for (int g = 0; g < 4; ++g) { const int d = 32 * c + 8 * g + 4 * hi; const u32x2 z = *(const u32x2*)(zrow + d);
            const f32x16& o = c ? o1 : o0;
            u32x2 w; w.x = cvtpk(o[4 * g] * inv * bflo(z.x), o[4 * g + 1] * inv * bfhi(z.x)); w.y = cvtpk(o[4 * g + 2] * inv * bflo(z.y), o[4 * g + 3] * inv * bfhi(z.y));
            *(u32x2*)(orow + d) = w; }
}

__device__ __forceinline__ void state_store(LAS unsigned char* ost, LAS float* ml, int lt, int hi, const f32x16& o0, const f32x16& o1, float m, float l) {
    const float lt_tot = pair_sum(l); const int gx = (lt ^ (lt >> 4)) & 15;
#pragma unroll
    for (int c = 0; c < 2; ++c)
#pragma unroll
        for (int g = 0; g < 4; ++g) { const f32x16& o = c ? o1 : o0; u32x2 w; w.x = cvtpk(o[4 * g], o[4 * g + 1]); w.y = cvtpk(o[4 * g + 2], o[4 * g + 3]);
            *(LAS u32x2*)(ost + lt * 128 + 8 * ((8 * c + 2 * g + hi) ^ gx)) = w; }
    if (hi == 0) { ml[2 * lt] = m; ml[2 * lt + 1] = lt_tot; }
}
__device__ __forceinline__ void state_load(const LAS unsigned char* ost, const LAS float* ml, int lt, int hi, f32x16& o0, f32x16& o1, float& m, float& l) {
    const int gx = (lt ^ (lt >> 4)) & 15;
#pragma unroll
    for (int c = 0; c < 2; ++c)
#pragma unroll
        for (int g = 0; g < 4; ++g) { const u32x2 w = *(const LAS u32x2*)(ost + lt * 128 + 8 * ((8 * c + 2 * g + hi) ^ gx));
            f32x16& o = c ? o1 : o0; o[4 * g] = bflo(w.x); o[4 * g + 1] = bfhi(w.x); o[4 * g + 2] = bflo(w.y); o[4 * g + 3] = bfhi(w.y); }
    m = ml[2 * lt]; const float lv = ml[2 * lt + 1]; l = hi == 0 ? lv : 0.f;
}

__device__ __forceinline__ void dilated_unit(Frame& F, int b, int h, int mt) {
    LAS unsigned char* ost = F.lds + P2_OST; LAS float* ml = (LAS float*)(F.lds + P2_ML); LAS unsigned char* vst = F.lds + P2_VST + F.wave * 4096;
    const int lane = F.lane, r32 = lane & 31, hi = lane >> 5;
    const bf16* qcol = F.PROJ + (size_t)b * SEQ * INC + h * 64;
    const float slope = __builtin_amdgcn_exp2f(-(float)(h + 1)) * LOG2E;
#pragma unroll 1
    for (int pass = 0; pass < 3; ++pass) {
        const int dil = pass == 0 ? 16 : (pass == 1 ? 4 : 1), L = SEQ / dil; const float cb = slope * (float)dil;
#pragma unroll 1
        for (int bb = 0; bb < 2; ++bb) {
            const int bi = 2 * F.wave + bb; int res, q0, lt;
            if (pass == 0) { res = bi; q0 = 32 * mt; lt = 16 * r32 + bi; }
            else if (pass == 1) { res = bi >> 2; q0 = 128 * mt + 32 * (bi & 3); lt = 128 * (bi & 3) + 4 * r32 + res; }
            else { res = 0; q0 = 512 * mt + 32 * bi; lt = 32 * bi + r32; }
            const int tokq = 512 * mt + lt;
            const bf16* qp = qcol + (size_t)tokq * INC + 8 * hi; bf16x8 qf[4];
#pragma unroll
            for (int d0 = 0; d0 < 4; ++d0) qf[d0] = *(const bf16x8*)(qp + 16 * d0);
            f32x16 o0, o1; float m, l;
            if (pass == 0) {
#pragma unroll
                for (int r = 0; r < 16; ++r) { o0[r] = 0.f; o1[r] = 0.f; }
                m = NEG_BIG; l = 0.f; }
            else state_load(ost, ml, lt, hi, o0, o1, m, l);
            attn_block<true>(o0, o1, m, l, qf, qcol + C_KA, qcol + C_VA, INC, q0, L, dil, res, cb, vst, lane);
            if (pass < 2) state_store(ost, ml, lt, hi, o0, o1, m, l);
            else attn_finish(o0, o1, l, qcol + (size_t)tokq * INC + C_ZA, F.GATED + ((size_t)b * SEQ + tokq) * DM + h * 64, hi);
        }
        __syncthreads();
    }
}
__device__ __forceinline__ void mem_unit(Frame& F, int b, int hm, int mt) {
    LAS unsigned char* vst = F.lds + P2_VST + F.wave * 4096;
    const int lane = F.lane, r32 = lane & 31, hi = lane >> 5;
    const bf16* kb = F.MKV + (size_t)b * NMEM * 512 + hm * 64;
#pragma unroll 1
    for (int bb = 0; bb < 2; ++bb) {
        const int tokq = 512 * mt + 32 * (2 * F.wave + bb) + r32;
        const bf16* prow = F.PROJ + ((size_t)b * SEQ + tokq) * INC;
        const bf16* qp = prow + C_QM + hm * 64 + 8 * hi; bf16x8 qf[4];
#pragma unroll
        for (int d0 = 0; d0 < 4; ++d0) qf[d0] = *(const bf16x8*)(qp + 16 * d0);
        f32x16 o0, o1; float m = NEG_BIG, l = 0.f;
#pragma unroll
        for (int r = 0; r < 16; ++r) { o0[r] = 0.f; o1[r] = 0.f; }
        attn_block<false>(o0, o1, m, l, qf, kb, kb + 256, 512, 0, NMEM, 1, 0, 0.f, vst, lane);
        attn_finish(o0, o1, l, prow + C_ZM + hm * 64, F.GATED + ((size_t)b * SEQ + tokq) * DM + 768 + hm * 64, hi);
    }
}
__device__ __forceinline__ void sgu_unit(Frame& F, int b, int n) {
    LAS unsigned char* vnt = F.lds;
    const int lane = F.lane, r32 = lane & 31, hi = lane >> 5;
    const size_t row0 = (size_t)b * SEQ + 128 * n;
    {   const int ch8 = lane & 31; const f32x4 g0 = *(const f32x4*)(F.g_v + 8 * ch8), g1 = *(const f32x4*)(F.g_v + 8 * ch8 + 4);
#pragma unroll 2
        for (int it = 0; it < 8; ++it) { const int row = F.wave * 16 + 2 * it + hi;
            const u32x4 v = *(const u32x4*)(F.PROJ + (row0 + row) * INC + C_VB + 8 * ch8);
            float f[8] = {bflo(v.x), bfhi(v.x), bflo(v.y), bfhi(v.y), bflo(v.z), bfhi(v.z), bflo(v.w), bfhi(v.w)};
            float ss = 0.f;
#pragma unroll
            for (int k = 0; k < 8; ++k) ss += f[k] * f[k];
#pragma unroll
            for (int o = 1; o < 32; o <<= 1) ss += __shfl_xor(ss, o);
            const float rstd = 1.f / sqrtf(ss * (1.f / 256.f) + RMS_EPS);
            u32x4 w; w.x = cvtpk(f[0] * rstd * g0.x, f[1] * rstd * g0.y); w.y = cvtpk(f[2] * rstd * g0.z, f[3] * rstd * g0.w);
            w.z = cvtpk(f[4] * rstd * g1.x, f[5] * rstd * g1.y); w.w = cvtpk(f[6] * rstd * g1.z, f[7] * rstd * g1.w);
            *(LAS u32x4*)(vnt + row * 512 + ((ch8 * 16) ^ ((row & 3) << 6))) = w; }
    }
    __syncthreads();
    {   const int cb = F.wave, g = cb >> 1;
        const int tq = (lane & 15) >> 2, tp = lane & 3, tblk = (lane >> 4) & 1;
        const LAS unsigned char* tr = vnt + (8 * hi + tq) * 512 + ((64 * cb + 32 * tblk + 8 * tp) ^ (tq << 6));
        bf16x8 af[8];
#pragma unroll
        for (int ks = 0; ks < 8; ++ks) { const s16x4 lo = vtr(tr + ks * 16 * 512), hi4 = vtr(tr + ks * 16 * 512 + 4 * 512); af[ks] = __builtin_shufflevector(lo, hi4, 0, 1, 2, 3, 4, 5, 6, 7); }
        const bf16* wg = F.WSB + (size_t)g * 128 * 128;
#pragma unroll 1
        for (int tb = 0; tb < 4; ++tb) {
            const int t = 32 * tb + r32; const bf16* wrow = wg + t * 128 + 8 * hi;
            f32x16 acc;
#pragma unroll
            for (int r = 0; r < 16; ++r) acc[r] = 0.f;
#pragma unroll
            for (int ks = 0; ks < 8; ++ks) { const bf16x8 bfr = *(const bf16x8*)(wrow + 16 * ks); acc = MFMA32(af[ks], bfr, acc); }
            const float bias = F.b_s[g * 128 + t];
            const bf16* prow = F.PROJ + (row0 + t) * INC; bf16* orow = F.GATED + (row0 + t) * DM + 512;
#pragma unroll
            for (int gq = 0; gq < 4; ++gq) { const int ch = 32 * cb + 8 * gq + 4 * hi;
                const u32x2 u = *(const u32x2*)(prow + C_UB + ch), z = *(const u32x2*)(prow + C_ZB + ch);
                u32x2 w; w.x = cvtpk((acc[4 * gq] + bias) * bflo(u.x) * bflo(z.x), (acc[4 * gq + 1] + bias) * bfhi(u.x) * bfhi(z.x));
                w.y = cvtpk((acc[4 * gq + 2] + bias) * bflo(u.y) * bflo(z.y), (acc[4 * gq + 3] + bias) * bfhi(u.y) * bfhi(z.y));
                *(u32x2*)(orow + ch) = w; }
        }
    }
    __syncthreads();
}
__device__ __forceinline__ void final_norm_row(float* row, const float* gain, int lane) {
    GAS f32x4* xr = (GAS f32x4*)row + lane; const GAS f32x4* gr = (const GAS f32x4*)gain + lane;
    f32x4 v[4]; float s = 0.f;
#pragma unroll
    for (int j = 0; j < 4; ++j) { v[j] = xr[64 * j]; s += (v[j].x * v[j].x + v[j].y * v[j].y) + (v[j].z * v[j].z + v[j].w * v[j].w); }
    const float rstd = 1.f / sqrtf(wave_sum(s) * (1.f / 1024.f) + RMS_EPS);
#pragma unroll
    for (int j = 0; j < 4; ++j) { const f32x4 g = gr[64 * j]; xr[64 * j] = v[j] * rstd * g; }
}

struct Args { const float* in[11]; float* out; unsigned char* ws; };
__global__ void __launch_bounds__(NWAVES * 64, 2) hybrid_fwd(Args args) {
    extern __shared__ __attribute__((aligned(16))) unsigned char lds[];
    Frame F;
    F.lds = (LAS unsigned char*)lds;
    F.MISC = (volatile LAS unsigned*)(F.lds + MISC_OFF);
    F.tid = threadIdx.x; F.lane = F.tid & 63; F.wave = __builtin_amdgcn_readfirstlane(F.tid >> 6);
    F.G = gridDim.x; { const int bx = blockIdx.x; F.vcu = (F.G % 8 == 0) ? (bx % 8) * (F.G / 8) + bx / 8 : bx; }
    unsigned char* ws = args.ws;
    F.ctl = (gu32*)(ws + WS_CTL);
    F.x = args.in[0]; F.mem = args.in[1]; F.g_norm = args.in[2]; F.w_in = args.in[3]; F.w_s = args.in[4]; F.b_s = args.in[5]; F.g_v = args.in[6];
    F.g_mem = args.in[7]; F.w_mkv = args.in[8]; F.w_out = args.in[9]; F.g_final = args.in[10]; F.out = args.out;
    F.BALL = (bf16*)(ws + WS_BALL); F.WOUT = (bf16*)(ws + WS_WOUT); F.WSB = (bf16*)(ws + WS_WS); F.AALL = (bf16*)(ws + WS_AALL);
    F.PROJ = (bf16*)(ws + WS_PROJ); F.MKV = (bf16*)(ws + WS_MKV); F.GATED = (bf16*)(ws + WS_GATED);
    for (int u = F.tid; u < (LDS_BYTES - LDSCTL_OFF) / 4; u += NWAVES * 64) ((LAS unsigned*)(F.lds + LDSCTL_OFF))[u] = 0u;
    __syncthreads();
    XcdBarrier bar = xcd_barrier_post((unsigned*)(F.ctl + CW_BAR), F.MISC + 8);

    p0_prologue(F);
    xcd_barrier(bar);
    {   pg8::Gemm g{F.AALL, F.BALL, NTOK + MEMROWS, INC + 512, DM}; pg8::SchedP1 S{F.G, (int)blockIdx.x};
        pg8::EpiProj E{F.PROJ, F.MKV};
        pg8::gemm_phase<pg8::EpiProj, pg8::SchedP1, true, true>(F.lds + RING_OFF, g, S, E);
    }
    xcd_barrier(bar);
    for (int u = F.vcu; u < 256; u += F.G) sgu_unit(F, u >> 4, u & 15);
    for (int u = F.vcu; u < 256; u += F.G) mem_unit(F, u >> 4, (u >> 2) & 3, u & 3);
    for (int u = 2 * F.vcu; u < 512; u += 2 * F.G) { dilated_unit(F, u >> 5, (u >> 2) & 7, u & 3); dilated_unit(F, (u + 1) >> 5, ((u + 1) >> 2) & 7, (u + 1) & 3); }
    xcd_barrier(bar);
    {   pg8::Gemm g{F.GATED, F.WOUT, NTOK, DM, DM}; pg8::StaticOrder S; S.init(NTOK, DM, F.G, (int)blockIdx.x);
        pg8::EpiRes E{F.x, F.out};
        pg8::gemm_phase<pg8::EpiRes, pg8::StaticOrder, true, true>(F.lds + RING_OFF, g, S, E);
    }
    xcd_barrier(bar);
    {   const int gw = F.vcu * NWAVES + F.wave, NGW = F.G * NWAVES;
        for (int m = gw; m < NTOK; m += NGW) final_norm_row(F.out + (size_t)m * DM, F.g_final, F.lane);
    }
}

extern "C" void kernel_launch(void* const* d_in, const int* in_sizes, int n_in, void* d_out, int out_size, void* d_ws, size_t ws_size, hipStream_t stream) {
    static int grid = 0;
    if (grid == 0) {
        if (n_in != 11 || in_sizes[0] != NTOK * DM || out_size != NTOK * DM || ws_size < WS_END) { fprintf(stderr, "kernel_launch: unexpected shapes (n_in %d, in0 %d, out %d, ws %zu)\n", n_in, n_in > 0 ? in_sizes[0] : -1, out_size, ws_size); grid = -1; return; }
        int dev = 0, cus = 0, per_cu = 0;
        if (hipGetDevice(&dev) != hipSuccess || hipDeviceGetAttribute(&cus, hipDeviceAttributeMultiprocessorCount, dev) != hipSuccess) { grid = -1; return; }
        if (hipFuncSetAttribute((const void*)hybrid_fwd, hipFuncAttributeMaxDynamicSharedMemorySize, LDS_BYTES) != hipSuccess) { fprintf(stderr, "kernel_launch: hipFuncSetAttribute failed\n"); grid = -1; return; }
        if (hipOccupancyMaxActiveBlocksPerMultiprocessor(&per_cu, (const void*)hybrid_fwd, NWAVES * 64, LDS_BYTES) != hipSuccess || per_cu < 1) { fprintf(stderr, "kernel_launch: occupancy query says %d blocks per CU\n", per_cu); per_cu = 1; }
        (void)hipGetLastError();
        grid = cus;
    }
    if (grid < 0) return;
    if (hipMemsetAsync((char*)d_ws + WS_CTL, 0, CTL_ZERO_BYTES, stream) != hipSuccess) { fprintf(stderr, "kernel_launch: memset failed\n"); return; }
    Args a{};
    for (int i = 0; i < 11; ++i) a.in[i] = (const float*)d_in[i];
    a.out = (float*)d_out; a.ws = (unsigned char*)d_ws;
    void* kargs[] = {&a};
    hipError_t e = hipLaunchCooperativeKernel((const void*)hybrid_fwd, dim3(grid), dim3(NWAVES * 64), kargs, LDS_BYTES, stream);
    if (e != hipSuccess) { (void)hipGetLastError(); fprintf(stderr, "kernel_launch: cooperative launch failed (%s), plain launch instead\n", hipGetErrorString(e));
        hipLaunchKernelGGL(hybrid_fwd, dim3(grid), dim3(NWAVES * 64), LDS_BYTES, stream, a); }
}
```
